# Optimizing an MI355X kernel written in HIP

```python
import jax, jax.numpy as jnp
from jax import lax
import numpy as np

D_MODEL = 1024
BATCH = 16
SEQ = 4096
DEPTH = 2
DEC_BATCH = 8
DEC_SEQ = 2048
PAST_LEN = 128

HEAD_DIM = 64
RET_HEADS = 4
FFT_GROUPS = 4
ATT_Q_HEADS = 4
ATT_KV_HEADS = 2
CONV_GROUPS = 4
RET_W = RET_HEADS * HEAD_DIM
FFT_W = FFT_GROUPS * HEAD_DIM
ATT_W = ATT_Q_HEADS * HEAD_DIM
ATT_KV_W = ATT_KV_HEADS * HEAD_DIM
CONV_W = CONV_GROUPS * HEAD_DIM
MIX_W = RET_W + FFT_W + ATT_W + CONV_W
PROJ_SPLITS = (RET_W, RET_W, RET_W, RET_W, FFT_W, ATT_W, ATT_KV_W, ATT_KV_W, CONV_W, CONV_W, CONV_W)
PROJ_W = 4 * RET_W + FFT_W + ATT_W + 2 * ATT_KV_W + 3 * CONV_W
D_FF = 4 * D_MODEL
PLE_DIM = 256
GRID_W = 64
RET_CHUNK = 128
Q_BLOCK = 128
CONV_WIDTH = 3
ROPE_BASE = 10000.0
NORM_EPS = 1e-6

kernel_name = 'hybrid_parallel_heads_bidir_encoder'


def _rmsnorm(x, w):
    xf = x.astype(jnp.float32)
    y = xf * lax.rsqrt(jnp.mean(xf * xf, axis=-1, keepdims=True) + NORM_EPS)
    return (y * w.astype(jnp.float32)).astype(x.dtype)


def _rope(x, ang):
    m = ang.shape[-1]
    cos = jnp.cos(ang)[None, :, None, :]
    sin = jnp.sin(ang)[None, :, None, :]
    x1, x2 = x[..., :m], x[..., m:]
    return jnp.concatenate([x1 * cos - x2 * sin, x2 * cos + x1 * sin], axis=-1)


def _retention_dir(q, k, v, log_g, strict):
    b, h, s, d = q.shape
    nc = s // RET_CHUNK
    qc = q.reshape(b, h, nc, RET_CHUNK, d)
    kc = k.reshape(b, h, nc, RET_CHUNK, d)
    vc = v.reshape(b, h, nc, RET_CHUNK, d)
    idx = jnp.arange(RET_CHUNK, dtype=jnp.float32)
    diff = idx[:, None] - idx[None, :]
    mask = (diff > 0) if strict else (diff >= 0)
    decay = jnp.where(mask[None], jnp.exp(jnp.where(mask, diff, 0.0)[None] * log_g[:, None, None]), 0.0)
    scores = jnp.einsum('bhncd,bhnmd->bhncm', qc, kc) * decay[None, :, None]
    inner = jnp.einsum('bhncm,bhnmd->bhncd', scores, vc)
    zeta = jnp.exp((RET_CHUNK - 1 - idx)[None, :] * log_g[:, None])
    kv = jnp.einsum('bhncd,bhnce->nbhde', kc * zeta[None, :, None, :, None], vc)
    g_chunk = jnp.exp(RET_CHUNK * log_g)[None, :, None, None]

    def step(state, kv_n):
        return state * g_chunk + kv_n, state

    _, prev = lax.scan(step, jnp.zeros((b, h, d, d), jnp.float32), kv)
    xi = jnp.exp((idx + 1.0)[None, :] * log_g[:, None])
    cross = jnp.einsum('bhncd,nbhde->bhnce', qc, prev) * xi[None, :, None, :, None]
    return (inner + cross).reshape(b, h, s, d)


def _retention_mixer(q, k, v, g, log_rate, gn_w):
    b, s, _ = q.shape
    dt = q.dtype
    t = jnp.arange(s, dtype=jnp.float32)
    inv = ROPE_BASE ** (-jnp.arange(HEAD_DIM // 2, dtype=jnp.float32) / (HEAD_DIM // 2))
    ang = t[:, None] * inv[None, :]
    qh = _rope(q.astype(jnp.float32).reshape(b, s, RET_HEADS, HEAD_DIM), ang)
    kh = _rope(k.astype(jnp.float32).reshape(b, s, RET_HEADS, HEAD_DIM), ang) * (HEAD_DIM ** -0.5)
    vh = v.astype(jnp.float32).reshape(b, s, RET_HEADS, HEAD_DIM)
    qh, kh, vh = (a.transpose(0, 2, 1, 3) for a in (qh, kh, vh))
    log_g = -jnp.exp(log_rate.astype(jnp.float32))
    fwd = _retention_dir(qh, kh, vh, log_g[0], False)
    bwd = jnp.flip(_retention_dir(jnp.flip(qh, 2), jnp.flip(kh, 2), jnp.flip(vh, 2), log_g[1], True), 2)
    o = (fwd + bwd).transpose(0, 2, 1, 3)
    mu = jnp.mean(o, axis=-1, keepdims=True)
    var = jnp.mean(jnp.square(o - mu), axis=-1, keepdims=True)
    o = ((o - mu) * lax.rsqrt(var + NORM_EPS)).reshape(b, s, RET_W) * gn_w.astype(jnp.float32)
    return (jax.nn.silu(g.astype(jnp.float32)) * o).astype(dt)


def _fourier_mixer(u):
    b, s, _ = u.shape
    uf = u.astype(jnp.float32).reshape(b, s, FFT_GROUPS, HEAD_DIM)
    y = jnp.real(jnp.fft.fft2(uf, axes=(1, 3), norm='ortho'))
    return y.reshape(b, s, FFT_W).astype(u.dtype)


def _attention_mixer(q, k, v, q_norm_w, k_norm_w):
    b, s, _ = q.shape
    dt = q.dtype
    grp = ATT_Q_HEADS // ATT_KV_HEADS
    rows = s // GRID_W
    r_idx, c_idx = jnp.meshgrid(jnp.arange(rows, dtype=jnp.float32), jnp.arange(GRID_W, dtype=jnp.float32), indexing='ij')
    r_idx = r_idx.reshape(-1)
    c_idx = c_idx.reshape(-1)
    half = HEAD_DIM // 2
    inv = ROPE_BASE ** (-jnp.arange(half // 2, dtype=jnp.float32) / (half // 2))
    ang_r = r_idx[:, None] * inv[None, :]
    ang_c = c_idx[:, None] * inv[None, :]

    def axial(a):
        af = a.astype(jnp.float32)
        return jnp.concatenate([_rope(af[..., :half], ang_r), _rope(af[..., half:], ang_c)], axis=-1).astype(dt)

    qh = axial(_rmsnorm(q.reshape(b, s, ATT_Q_HEADS, HEAD_DIM), q_norm_w))
    kh = axial(_rmsnorm(k.reshape(b, s, ATT_KV_HEADS, HEAD_DIM), k_norm_w))
    vh = v.reshape(b, s, ATT_KV_HEADS, HEAD_DIM)
    qh = qh.reshape(b, s, ATT_KV_HEADS, grp, HEAD_DIM).transpose(0, 2, 3, 1, 4)
    kh = kh.transpose(0, 2, 1, 3)
    vh = vh.transpose(0, 2, 1, 3)
    nb = s // Q_BLOCK
    qb = jnp.moveaxis(qh.reshape(b, ATT_KV_HEADS, grp, nb, Q_BLOCK, HEAD_DIM), 3, 0)
    scale = HEAD_DIM ** -0.5

    def attend(qblk):
        sc = jnp.einsum('bkgqd,bksd->bkgqs', qblk, kh).astype(jnp.float32) * scale
        pr = jax.nn.softmax(sc, axis=-1)
        return jnp.einsum('bkgqs,bksd->bkgqd', pr.astype(vh.dtype), vh)

    o = lax.map(attend, qb)
    o = jnp.moveaxis(o, 0, 3).reshape(b, ATT_KV_HEADS, grp, s, HEAD_DIM)
    return o.transpose(0, 3, 1, 2, 4).reshape(b, s, ATT_W)


def _conv_mixer(b_gate, c_gate, h, conv_w):
    s = h.shape[1]
    pad = CONV_WIDTH // 2
    z = c_gate * h
    zp = jnp.pad(z, ((0, 0), (pad, pad), (0, 0)))
    y = zp[:, 0:s] * conv_w[0]
    for j in range(1, CONV_WIDTH):
        y = y + zp[:, j:j + s] * conv_w[j]
    return b_gate * y


def _encode(x, p, norm_mix_w, w_in, ret_log_rate, ret_gn_w, q_norm_w, k_norm_w, conv_w, w_out,
            norm_ffn_w, w_ffn1, w_ffn2, norm_pl_w, w_pl_gate, w_pl_proj, final_norm_w):
    offsets = np.cumsum(PROJ_SPLITS)[:-1].tolist()
    for l in range(DEPTH):
        h = _rmsnorm(x, norm_mix_w[l])
        proj = h @ w_in[l]
        rq, rk, rv, rg, fu, aq, ak, av, cb, cc, ch = jnp.split(proj, offsets, axis=-1)
        y_ret = _retention_mixer(rq, rk, rv, rg, ret_log_rate[l], ret_gn_w[l])
        y_fft = _fourier_mixer(fu)
        y_att = _attention_mixer(aq, ak, av, q_norm_w[l], k_norm_w[l])
        y_conv = _conv_mixer(cb, cc, ch, conv_w[l])
        mixed = jnp.concatenate([y_ret, y_fft, y_att, y_conv], axis=-1)
        x = x + mixed @ w_out[l]
        hf = _rmsnorm(x, norm_ffn_w[l]) @ w_ffn1[l]
        x = x + jnp.square(jax.nn.relu(hf)) @ w_ffn2[l]
        gate = jax.nn.sigmoid(_rmsnorm(x, norm_pl_w[l]) @ w_pl_gate[l])
        x = x + gate * (p[l] @ w_pl_proj[l])
    return _rmsnorm(x, final_norm_w)


def setup_inputs(seed: int = 0) -> dict:
    key = jax.random.key(seed)
    ks = jax.random.split(key, 20)
    f32 = jnp.float32
    nrm = lambda k, shape, scale: jax.random.normal(k, shape, f32) * scale
    base_rate = -(5.0 + jnp.arange(RET_HEADS, dtype=f32)) * jnp.log(2.0)
    return {
        'x_prompt': nrm(ks[0], (BATCH, SEQ, D_MODEL), 1.0),
        'x_sample': nrm(ks[1], (DEC_BATCH, DEC_SEQ, D_MODEL), 1.0),
        'p_prompt': nrm(ks[2], (DEPTH, BATCH, SEQ, PLE_DIM), 1.0),
        'p_sample': nrm(ks[3], (DEPTH, DEC_BATCH, DEC_SEQ, PLE_DIM), 1.0),
        'norm_mix_w': 1.0 + nrm(ks[4], (DEPTH, D_MODEL), 0.02),
        'w_in': nrm(ks[5], (DEPTH, D_MODEL, PROJ_W), D_MODEL ** -0.5),
        'ret_log_rate': base_rate[None, None, :] + nrm(ks[6], (DEPTH, 2, RET_HEADS), 0.1),
        'ret_gn_w': 1.0 + nrm(ks[7], (DEPTH, RET_W), 0.02),
        'q_norm_w': 1.0 + nrm(ks[8], (DEPTH, HEAD_DIM), 0.02),
        'k_norm_w': 1.0 + nrm(ks[9], (DEPTH, HEAD_DIM), 0.02),
        'conv_w': nrm(ks[10], (DEPTH, CONV_WIDTH, CONV_W), CONV_WIDTH ** -0.5),
        'w_out': nrm(ks[11], (DEPTH, MIX_W, D_MODEL), MIX_W ** -0.5),
        'norm_ffn_w': 1.0 + nrm(ks[12], (DEPTH, D_MODEL), 0.02),
        'w_ffn1': nrm(ks[13], (DEPTH, D_MODEL, D_FF), D_MODEL ** -0.5),
        'w_ffn2': nrm(ks[14], (DEPTH, D_FF, D_MODEL), D_FF ** -0.5),
        'norm_pl_w': 1.0 + nrm(ks[15], (DEPTH, D_MODEL), 0.02),
        'w_pl_gate': nrm(ks[16], (DEPTH, D_MODEL, D_MODEL), D_MODEL ** -0.5),
        'w_pl_proj': nrm(ks[17], (DEPTH, PLE_DIM, D_MODEL), PLE_DIM ** -0.5),
        'final_norm_w': 1.0 + nrm(ks[18], (D_MODEL,), 0.02),
    }


def reference(x_prompt, x_sample, p_prompt, p_sample, norm_mix_w, w_in, ret_log_rate, ret_gn_w,
              q_norm_w, k_norm_w, conv_w, w_out, norm_ffn_w, w_ffn1, w_ffn2, norm_pl_w, w_pl_gate,
              w_pl_proj, final_norm_w):
    y_prompt = _encode(x_prompt, p_prompt, norm_mix_w, w_in, ret_log_rate, ret_gn_w, q_norm_w, k_norm_w,
                       conv_w, w_out, norm_ffn_w, w_ffn1, w_ffn2, norm_pl_w, w_pl_gate, w_pl_proj, final_norm_w)
    y_sample = _encode(x_sample, p_sample, norm_mix_w, w_in, ret_log_rate, ret_gn_w, q_norm_w, k_norm_w,
                       conv_w, w_out, norm_ffn_w, w_ffn1, w_ffn2, norm_pl_w, w_pl_gate, w_pl_proj, final_norm_w)
    return (y_prompt, y_sample)
```

```cpp
#include <hip/hip_runtime.h>
#include <hip/hip_cooperative_groups.h>
#include <cstdio>
namespace cg = cooperative_groups;

#define LAS __attribute__((address_space(3)))
#define DI __device__ __forceinline__
typedef unsigned short bf16_t;
typedef short bf16x8 __attribute__((ext_vector_type(8)));
typedef short s16x4 __attribute__((ext_vector_type(4)));
typedef float f32x4 __attribute__((ext_vector_type(4)));
typedef float f32x16 __attribute__((ext_vector_type(16)));
typedef unsigned u32x4 __attribute__((ext_vector_type(4)));
typedef unsigned u32x2 __attribute__((ext_vector_type(2)));

constexpr int T = 81920, TP = 65536, TS = 16384, DM = 1024, NPROJ = 2304, DFF = 4096;
constexpr float EPS = 1e-6f;
constexpr size_t MiB = 1u << 20;
constexpr size_t WS_XB = 0, WS_RPART = 0, WS_VT = 80 * MiB;
constexpr size_t WS_BIG = 160 * MiB, WS_PROJ = WS_BIG, WS_PQT = WS_BIG + 360 * MiB, WS_MIXED = WS_BIG + 440 * MiB, WS_HIDDEN = WS_BIG, WS_PP = WS_BIG;
constexpr size_t WS_W = 800 * MiB, W_LAYER = 26 * MiB, W_IN = 0, W_OUT = 5767168, W_1 = W_OUT + 2 * MiB, W_2 = W_1 + 8 * MiB, W_G = W_2 + 8 * MiB, W_P = W_G + 2 * MiB;
constexpr size_t WS_DFT4 = 852 * MiB, WS_DFT2 = 916 * MiB, WS_PBF = 932 * MiB, WS_ROWSS = 972 * MiB, WS_ROPE = 975 * MiB, WS_END = 977 * MiB;
constexpr int LDS_BYTES = 131072;
constexpr int NRET = 96;

struct Args { const float* in[19]; float* out; unsigned char* ws; };

DI unsigned pk_bf16(float lo, float hi) {
  typedef __bf16 bf2 __attribute__((ext_vector_type(2)));
  typedef float f2 __attribute__((ext_vector_type(2)));
  f2 v = {lo, hi};
  bf2 b = __builtin_convertvector(v, bf2);
  return __builtin_bit_cast(unsigned, b);
}
DI float bflo(unsigned u) { return __uint_as_float(u << 16); }
DI float bfhi(unsigned u) { return __uint_as_float(u & 0xffff0000u); }
DI u32x4 pk8(const f32x4 a, const f32x4 b) { u32x4 w; w.x = pk_bf16(a[0], a[1]); w.y = pk_bf16(a[2], a[3]); w.z = pk_bf16(b[0], b[1]); w.w = pk_bf16(b[2], b[3]); return w; }
DI void unpk8(const u32x4 w, float (&f)[8]) { f[0] = bflo(w.x); f[1] = bfhi(w.x); f[2] = bflo(w.y); f[3] = bfhi(w.y); f[4] = bflo(w.z); f[5] = bfhi(w.z); f[6] = bflo(w.w); f[7] = bfhi(w.w); }
DI float ex2(float x) { return __builtin_amdgcn_exp2f(x); }
#define MFMA32(a, b, c) __builtin_amdgcn_mfma_f32_32x32x16_bf16((a), (b), (c), 0, 0, 0)

namespace pg8 {
constexpr int BM = 256, BK = 64, HALF = 128, HTB = HALF * BK * 2, STAGE_BYTES = 8 * HTB, NXCD = 8, WGM = 8;
DI int lds_byte(int r, int c) { const int st = (r >> 4) * 2 + (c >> 5), rr = r & 15, cc = c & 31, ob = rr * 64 + cc * 2; return st * 1024 + (ob ^ (((ob >> 9) & 1) << 5)); }
DI void stage_rc(int b, int& R, int& C) { const int st = b / 1024, sb = b % 1024, swz = sb ^ (((sb >> 9) & 1) << 5); R = (st >> 1) * 16 + swz / 64; C = (st & 1) * 32 + (swz % 64) / 2; }
DI int perm32(int rho) { const int n = rho >> 4, i = rho & 15; return 8 * (i >> 2) + 4 * n + (i & 3); }
struct Unit { int pm, pn; };
struct Gemm { const bf16_t* A; const bf16_t* Bt; int M, N, K; };
struct StaticOrder {
    int nM, nN, nwg, G, c;
    DI void init(int M, int N, int G_, int c_) { nM = M / BM; nN = N / BM; nwg = nM * nN; G = G_; c = c_; }
    DI bool next(int i, Unit& u) const {
        const long L = (long)i * G + c; if (L >= nwg) return false;
        int wgid = (int)L; { const int q = nwg / NXCD, r = nwg % NXCD, xcd = wgid % NXCD, off = wgid / NXCD; wgid = (xcd < r ? xcd * (q + 1) : r * (q + 1) + (xcd - r) * q) + off; }
        const int nig = WGM * nN, gid = wgid / nig, fm = gid * WGM, gsz = (nM - fm) < WGM ? (nM - fm) : WGM;
        u.pm = fm + ((wgid % nig) % gsz); u.pn = (wgid % nig) / gsz; return true;
    }
    DI void a_ready(const Unit&) const {}
    DI void done(const Unit&) const {}
};

template <class Epi, class Sched>
DI void gemm_phase(LAS unsigned char* lds, const Gemm g, const Sched& S, const Epi& E) {
    int tid = threadIdx.x; asm volatile("" : "+v"(tid));
    const int wid = __builtin_amdgcn_readfirstlane(tid >> 6), lane = tid & 63, wr = wid >> 2, wc = wid & 3, fr = lane & 15, fq = lane >> 4;
    const int K = g.K, nt = K / BK;
    unsigned voffA[2], voffB[2];
#pragma unroll
    for (int i = 0; i < 2; ++i) { int R, C; stage_rc(tid * 16 + i * 8192, R, C); const int Rb = Epi::PERM ? ((R & ~31) + perm32(R & 31)) : R;
        voffA[i] = (unsigned)(R * K + C) * 2u; voffB[i] = (unsigned)(Rb * K + C) * 2u; }
    const size_t kstep = (size_t)(BK * 2);
    const size_t hstep = (size_t)HALF * K * 2;
    const size_t tstep = 2 * hstep;
    const unsigned ldsw = (unsigned)wid * 1024u;
    const int aoff = lds_byte(wr * 64 + fr, fq * 8), boff = lds_byte(wc * 32 + fr, fq * 8);
#define PG8_SA(b, h) (((b) * 2 + (h)) * HTB)
#define PG8_SB(b, h) ((4 + (b) * 2 + (h)) * HTB)
#define PG8_STAGE(bufoff, gbase, voff) do { _Pragma("unroll") for (int _i = 0; _i < 2; ++_i) \
        __builtin_amdgcn_global_load_lds((const unsigned*)((const char*)(gbase) + (voff)[_i]), (LAS unsigned*)(lds + (bufoff) + ldsw + _i * 8192), 16, 0, 0); } while (0)
#define PG8_LDA(dst, b, h) do { _Pragma("unroll") for (int m = 0; m < 4; ++m) _Pragma("unroll") for (int k = 0; k < 2; ++k) dst[m][k] = *(const LAS bf16x8*)(lds + PG8_SA(b, h) + aoff + m * 2048 + k * 1024); } while (0)
#define PG8_LDB(dst, b, h) do { _Pragma("unroll") for (int n = 0; n < 2; ++n) _Pragma("unroll") for (int k = 0; k < 2; ++k) dst[n][k] = *(const LAS bf16x8*)(lds + PG8_SB(b, h) + boff + n * 2048 + k * 1024); } while (0)
#define PG8_MMA(ai, bj, At, Bt) do { __builtin_amdgcn_s_setprio(1); _Pragma("unroll") for (int m = 0; m < 4; ++m) _Pragma("unroll") for (int n = 0; n < 2; ++n) _Pragma("unroll") for (int k = 0; k < 2; ++k) \
        acc[ai][bj][m][n] = __builtin_amdgcn_mfma_f32_16x16x32_bf16(Bt[n][k], At[m][k], acc[ai][bj][m][n], 0, 0, 0); __builtin_amdgcn_s_setprio(0); } while (0)
#define PG8_WAIT_V(n) asm volatile("s_waitcnt vmcnt(" #n ")" ::: "memory")
#define PG8_WAIT_L(n) asm volatile("s_waitcnt lgkmcnt(" #n ")" ::: "memory")
#define PG8_BAR __builtin_amdgcn_s_barrier()
#define PG8_SCHED __builtin_amdgcn_sched_barrier(0)
    Unit cur, nxt; int ui = 0;
    if (!S.next(0, cur)) return;
    f32x4 acc[2][2][4][2];
#pragma unroll
    for (int a = 0; a < 2; ++a)
#pragma unroll
        for (int b = 0; b < 2; ++b)
#pragma unroll
            for (int m = 0; m < 4; ++m)
#pragma unroll
                for (int n = 0; n < 2; ++n) acc[a][b][m][n] = (f32x4){0.f, 0.f, 0.f, 0.f};
    bf16x8 At[4][2], B0[2][2], B1[2][2];
    const char* cA = (const char*)g.A + (size_t)cur.pm * tstep; const char* cB = (const char*)g.Bt + (size_t)cur.pn * tstep;
    S.a_ready(cur);
    PG8_STAGE(PG8_SB(0, 0), cB, voffB); PG8_STAGE(PG8_SA(0, 0), cA, voffA); PG8_STAGE(PG8_SB(0, 1), cB + hstep, voffB); PG8_STAGE(PG8_SA(0, 1), cA + hstep, voffA);
    if (wr == 1) PG8_BAR;
    PG8_WAIT_V(4); PG8_BAR;
    PG8_STAGE(PG8_SB(1, 0), cB + kstep, voffB); PG8_STAGE(PG8_SA(1, 0), cA + kstep, voffA); PG8_STAGE(PG8_SB(1, 1), cB + hstep + kstep, voffB);
    PG8_WAIT_V(6); PG8_BAR;
    for (;;) {
        const bool has_next = S.next(ui + 1, nxt);
        const char* nA = has_next ? (const char*)g.A + (size_t)nxt.pm * tstep : cA; const char* nB = has_next ? (const char*)g.Bt + (size_t)nxt.pn * tstep : cB;
        for (int t = 0; t < nt; t += 2) {
            const bool last = (t == nt - 2);
            const char* a1 = cA + (size_t)(t + 1) * kstep;
            const char* a2 = last ? nA : cA + (size_t)(t + 2) * kstep; const char* b2 = last ? nB : cB + (size_t)(t + 2) * kstep;
            const char* a3 = a2 + kstep; const char* b3 = b2 + kstep;
            if (last && has_next) S.a_ready(nxt);
            PG8_LDB(B0, 0, 0); PG8_SCHED; PG8_LDA(At, 0, 0); PG8_STAGE(PG8_SA(1, 1), a1 + hstep, voffA);
            PG8_WAIT_L(8); PG8_BAR; PG8_WAIT_L(0); PG8_MMA(0, 0, At, B0); PG8_BAR; PG8_SCHED;
            PG8_LDB(B1, 0, 1); PG8_STAGE(PG8_SB(0, 0), b2, voffB);
            PG8_BAR; PG8_WAIT_L(0); PG8_MMA(0, 1, At, B1); PG8_BAR;
            PG8_LDA(At, 0, 1); PG8_STAGE(PG8_SA(0, 0), a2, voffA);
            PG8_BAR; PG8_WAIT_L(0); PG8_MMA(1, 0, At, B0); PG8_BAR; PG8_SCHED;
            PG8_STAGE(PG8_SB(0, 1), b2 + hstep, voffB);
            PG8_WAIT_V(6); PG8_BAR; PG8_MMA(1, 1, At, B1); PG8_BAR;
            PG8_LDB(B0, 1, 0); PG8_SCHED; PG8_LDA(At, 1, 0); PG8_STAGE(PG8_SA(0, 1), a2 + hstep, voffA);
            PG8_WAIT_L(8); PG8_BAR; PG8_WAIT_L(0); PG8_MMA(0, 0, At, B0); PG8_BAR; PG8_SCHED;
            PG8_LDB(B1, 1, 1); PG8_STAGE(PG8_SB(1, 0), b3, voffB);
            PG8_BAR; PG8_WAIT_L(0); PG8_MMA(0, 1, At, B1); PG8_BAR;
            PG8_LDA(At, 1, 1); PG8_STAGE(PG8_SA(1, 0), a3, voffA);
            PG8_BAR; PG8_WAIT_L(0); PG8_MMA(1, 0, At, B0); PG8_BAR; PG8_SCHED;
            PG8_STAGE(PG8_SB(1, 1), b3 + hstep, voffB);
            PG8_WAIT_V(6); PG8_BAR; PG8_MMA(1, 1, At, B1); PG8_BAR;
        }
        E(acc, cur, wr, wc, fr, fq); S.done(cur);
        if (!has_next) break;
#pragma unroll
        for (int a = 0; a < 2; ++a)
#pragma unroll
            for (int b = 0; b < 2; ++b)
#pragma unroll
                for (int m = 0; m < 4; ++m)
#pragma unroll
                    for (int n = 0; n < 2; ++n) acc[a][b][m][n] = (f32x4){0.f, 0.f, 0.f, 0.f};
        cur = nxt; cA = nA; cB = nB; ++ui;
    }
    PG8_WAIT_V(0);
    if (wr == 0) PG8_BAR;
    PG8_BAR;
#undef PG8_SA
#undef PG8_SB
#undef PG8_STAGE
#undef PG8_LDA
#undef PG8_LDB
#undef PG8_MMA
#undef PG8_WAIT_V
#undef PG8_WAIT_L
#undef PG8_BAR
#undef PG8_SCHED
}
}
using pg8::Unit;

#define EPI_ROWS _Pragma("unroll") for (int ai = 0; ai < 2; ++ai) _Pragma("unroll") for (int m = 0; m < 4; ++m)
#define EPI_BJ _Pragma("unroll") for (int bj = 0; bj < 2; ++bj)
typedef const f32x4 (&AccRef)[2][2][4][2];

struct EpiProj {
    static constexpr bool PERM = true;
    bf16_t* O; const float* rowss;
    DI void operator()(AccRef acc, const Unit& u, int wr, int wc, int fr, int fq) const {
        const int row0 = u.pm * 256 + wr * 64 + fr, col0 = u.pn * 256 + wc * 32 + 8 * fq;
        EPI_ROWS { const int r = row0 + ai * 128 + m * 16; const float rs = rsqrtf(rowss[r] * (1.f / 1024.f) + EPS);
            bf16_t* rowp = O + (size_t)r * NPROJ + col0;
            EPI_BJ { *(u32x4*)(rowp + bj * 128) = pk8(acc[ai][bj][m][0] * rs, acc[ai][bj][m][1] * rs); } }
    }
};
struct EpiPQ {
    static constexpr bool PERM = true;
    bf16_t* PQT; const float* rowss;
    DI void operator()(AccRef acc, const Unit& u, int wr, int wc, int fr, int fq) const {
        const int tstart = u.pn * 256; int S, pos0; size_t base;
        if (tstart < TP) { S = 4096; base = (size_t)(tstart >> 12) * 256 * 8192; pos0 = tstart & 4095; }
        else { const int ts = tstart - TP; S = 2048; base = (size_t)16 * 256 * 8192 + (size_t)(ts >> 11) * 256 * 4096; pos0 = ts & 2047; }
        const int tcol = wc * 32 + 8 * fq;
        f32x4 rs[2][2];
        EPI_BJ { _Pragma("unroll") for (int n = 0; n < 2; ++n) { const f32x4 s = *(const f32x4*)(rowss + tstart + tcol + bj * 128 + 4 * n);
            rs[bj][n] = (f32x4){rsqrtf(s[0] * (1.f / 1024.f) + EPS), rsqrtf(s[1] * (1.f / 1024.f) + EPS), rsqrtf(s[2] * (1.f / 1024.f) + EPS), rsqrtf(s[3] * (1.f / 1024.f) + EPS)}; } }
        EPI_ROWS { const int c = ai * 128 + wr * 64 + m * 16 + fr;
            bf16_t* rowp = PQT + base + (size_t)c * (2 * S) + (u.pm ? S : 0) + pos0 + tcol;
            EPI_BJ { *(u32x4*)(rowp + bj * 128) = pk8(acc[ai][bj][m][0] * rs[bj][0], acc[ai][bj][m][1] * rs[bj][1]); } }
    }
};
struct EpiResid {
    static constexpr bool PERM = true;
    const float* xin_p; const float* xin_s; float* xout; bf16_t* xb; float* rowss_out;
    DI void operator()(AccRef acc, const Unit& u, int wr, int wc, int fr, int fq) const {
        const int row0 = u.pm * 256 + wr * 64 + fr, col0 = u.pn * 256 + wc * 32 + 8 * fq;
        EPI_ROWS { const int r = row0 + ai * 128 + m * 16;
            const float* src = (r < TP ? xin_p + (size_t)r * DM : xin_s + (size_t)(r - TP) * DM) + col0;
            float* dst = xout + (size_t)r * DM + col0; bf16_t* dstb = xb + (size_t)r * DM + col0; float ss = 0.f;
            EPI_BJ { const f32x4 o0 = *(const f32x4*)(src + bj * 128) + acc[ai][bj][m][0], o1 = *(const f32x4*)(src + bj * 128 + 4) + acc[ai][bj][m][1];
                *(f32x4*)(dst + bj * 128) = o0; *(f32x4*)(dst + bj * 128 + 4) = o1; *(u32x4*)(dstb + bj * 128) = pk8(o0, o1);
                ss += (o0[0] * o0[0] + o0[1] * o0[1]) + (o0[2] * o0[2] + o0[3] * o0[3]) + (o1[0] * o1[0] + o1[1] * o1[1]) + (o1[2] * o1[2] + o1[3] * o1[3]); }
            ss += __shfl_xor(ss, 16); ss += __shfl_xor(ss, 32);
            if (fq == 0) atomicAdd(rowss_out + r, ss); }
    }
};
struct EpiFfn1 {
    static constexpr bool PERM = true;
    bf16_t* O; const float* rowss;
    DI void operator()(AccRef acc, const Unit& u, int wr, int wc, int fr, int fq) const {
        const int row0 = u.pm * 256 + wr * 64 + fr, col0 = u.pn * 256 + wc * 32 + 8 * fq;
        EPI_ROWS { const int r = row0 + ai * 128 + m * 16; const float rs = rsqrtf(rowss[r] * (1.f / 1024.f) + EPS);
            bf16_t* rowp = O + (size_t)r * DFF + col0;
            EPI_BJ { f32x4 v0 = acc[ai][bj][m][0] * rs, v1 = acc[ai][bj][m][1] * rs;
                _Pragma("unroll") for (int j = 0; j < 4; ++j) { v0[j] = fmaxf(v0[j], 0.f); v0[j] *= v0[j]; v1[j] = fmaxf(v1[j], 0.f); v1[j] *= v1[j]; }
                *(u32x4*)(rowp + bj * 128) = pk8(v0, v1); } }
    }
};
struct EpiPP {
    static constexpr bool PERM = true;
    bf16_t* O;
    DI void operator()(AccRef acc, const Unit& u, int wr, int wc, int fr, int fq) const {
        const int row0 = u.pm * 256 + wr * 64 + fr, col0 = u.pn * 256 + wc * 32 + 8 * fq;
        EPI_ROWS { const int r = row0 + ai * 128 + m * 16; bf16_t* rowp = O + (size_t)r * DM + col0;
            EPI_BJ { *(u32x4*)(rowp + bj * 128) = pk8(acc[ai][bj][m][0], acc[ai][bj][m][1]); } }
    }
};
struct EpiGate {
    static constexpr bool PERM = true;
    const float* rowss_in; const bf16_t* pp; float* x; bf16_t* xb; float* rowss_out;
    DI void operator()(AccRef acc, const Unit& u, int wr, int wc, int fr, int fq) const {
        const int row0 = u.pm * 256 + wr * 64 + fr, col0 = u.pn * 256 + wc * 32 + 8 * fq;
        EPI_ROWS { const int r = row0 + ai * 128 + m * 16; const float rs = rsqrtf(rowss_in[r] * (1.f / 1024.f) + EPS);
            float* dst = x + (size_t)r * DM + col0; bf16_t* dstb = xb + (size_t)r * DM + col0; const bf16_t* ppr = pp + (size_t)r * DM + col0; float ss = 0.f;
            EPI_BJ { float pv[8]; unpk8(*(const u32x4*)(ppr + bj * 128), pv);
                f32x4 o0 = *(const f32x4*)(dst + bj * 128), o1 = *(const f32x4*)(dst + bj * 128 + 4);
                _Pragma("unroll") for (int j = 0; j < 4; ++j) { const float g0 = 1.f / (1.f + __expf(-acc[ai][bj][m][0][j] * rs)), g1 = 1.f / (1.f + __expf(-acc[ai][bj][m][1][j] * rs));
                    o0[j] += g0 * pv[j]; o1[j] += g1 * pv[4 + j]; }
                *(f32x4*)(dst + bj * 128) = o0; *(f32x4*)(dst + bj * 128 + 4) = o1; *(u32x4*)(dstb + bj * 128) = pk8(o0, o1);
                ss += (o0[0] * o0[0] + o0[1] * o0[1]) + (o0[2] * o0[2] + o0[3] * o0[3]) + (o1[0] * o1[0] + o1[1] * o1[1]) + (o1[2] * o1[2] + o1[3] * o1[3]); }
            ss += __shfl_xor(ss, 16); ss += __shfl_xor(ss, 32);
            if (fq == 0) atomicAdd(rowss_out + r, ss); }
    }
};
struct EpiDft {
    static constexpr bool PERM = true;
    bf16_t* mixed; float scale; int tok_base, seq_len;
    DI void operator()(AccRef acc, const Unit& u, int wr, int wc, int fr, int fq) const {
        const int row0 = tok_base + u.pn * seq_len + u.pm * 256 + wr * 64 + fr, col0 = 256 + wc * 32 + 8 * fq;
        EPI_ROWS { const int r = row0 + ai * 128 + m * 16; bf16_t* rowp = mixed + (size_t)r * DM + col0;
            EPI_BJ { *(u32x4*)(rowp + bj * 128) = pk8(acc[ai][bj][m][0] * scale, acc[ai][bj][m][1] * scale); } }
    }
};

DI void transpose_tiles(LAS float* tile, const float* src, int ldsrc, int K, int N, bf16_t* dst, const float* nw, int split_at, int split_skip, int& tcount, int gstride, int gofs) {
    const int tid = threadIdx.x, ntk = K / 64, ntn = N / 64;
    for (int t = 0; t < ntk * ntn; ++t, ++tcount) {
        if ((tcount % gstride) != gofs) continue;
        const int k0 = (t % ntk) * 64, n0 = (t / ntk) * 64, sc0 = n0 < split_at ? n0 : n0 + split_skip;
        __syncthreads();
#pragma unroll
        for (int it = 0; it < 8; ++it) { const int kk = (tid >> 6) + 8 * it, nn = tid & 63;
            float v = src[(size_t)(k0 + kk) * ldsrc + sc0 + nn]; if (nw) v *= nw[k0 + kk]; tile[kk * 65 + nn] = v; }
        __syncthreads();
        { const int nn = tid >> 3, kc = (tid & 7) * 8; f32x4 a, b;
#pragma unroll
          for (int j = 0; j < 4; ++j) { a[j] = tile[(kc + j) * 65 + nn]; b[j] = tile[(kc + 4 + j) * 65 + nn]; }
          *(u32x4*)(dst + (size_t)(n0 + nn) * K + k0 + kc) = pk8(a, b); }
    }
}

DI void phase_prep(LAS unsigned char* lds, const Args& a) {
    int tid = threadIdx.x; asm volatile("" : "+v"(tid));
    const int G = gridDim.x, b = blockIdx.x;
    unsigned char* ws = a.ws;
    LAS float* tile = (LAS float*)lds;
    LAS float* ctab = (LAS float*)(lds + 20480);
    if (tid < 64) { float s, c; sincospif((float)tid / 32.f, &s, &c); ctab[tid] = c; ctab[64 + tid] = s; }
    int tc = 0;
    for (int l = 0; l < 2; ++l) {
        unsigned char* wl = ws + WS_W + (size_t)l * W_LAYER;
        transpose_tiles(tile, a.in[5] + (size_t)l * DM * 2560, 2560, DM, NPROJ, (bf16_t*)(wl + W_IN), a.in[4] + l * DM, 1024, 256, tc, G, b);
        transpose_tiles(tile, a.in[11] + (size_t)l * DM * DM, DM, DM, DM, (bf16_t*)(wl + W_OUT), nullptr, 1 << 30, 0, tc, G, b);
        transpose_tiles(tile, a.in[13] + (size_t)l * DM * DFF, DFF, DM, DFF, (bf16_t*)(wl + W_1), a.in[12] + l * DM, 1 << 30, 0, tc, G, b);
        transpose_tiles(tile, a.in[14] + (size_t)l * DFF * DM, DM, DFF, DM, (bf16_t*)(wl + W_2), nullptr, 1 << 30, 0, tc, G, b);
        transpose_tiles(tile, a.in[16] + (size_t)l * DM * DM, DM, DM, DM, (bf16_t*)(wl + W_G), a.in[15] + l * DM, 1 << 30, 0, tc, G, b);
        transpose_tiles(tile, a.in[17] + (size_t)l * 256 * DM, DM, 256, DM, (bf16_t*)(wl + W_P), nullptr, 1 << 30, 0, tc, G, b);
        for (int t = 0; t < 64; ++t, ++tc) {
            if ((tc % G) != b) continue;
            const int k0 = (t & 15) * 64, g = t >> 4;
            const float* src = a.in[5] + (size_t)l * DM * 2560; const float* nw = a.in[4] + l * DM;
            __syncthreads();
#pragma unroll
            for (int it = 0; it < 8; ++it) { const int kk = (tid >> 6) + 8 * it, nn = tid & 63;
                tile[kk * 65 + nn] = src[(size_t)(k0 + kk) * 2560 + 1024 + 64 * g + nn] * nw[k0 + kk]; }
            __syncthreads();
            const int j = tid >> 3, kc = (tid & 7) * 8;
            float p[8], q[8];
#pragma unroll
            for (int e = 0; e < 8; ++e) { p[e] = 0.f; q[e] = 0.f; }
            for (int jp = 0; jp < 64; ++jp) { const int mi = (j * jp) & 63; const float c = ctab[mi], s = ctab[64 + mi];
#pragma unroll
                for (int e = 0; e < 8; ++e) { const float v = tile[(kc + e) * 65 + jp]; p[e] += v * c; q[e] += v * s; } }
            bf16_t* dst = (bf16_t*)(wl + W_IN);
            *(u32x4*)(dst + (size_t)(2304 + 64 * g + j) * DM + k0 + kc) = pk8((f32x4){p[0], p[1], p[2], p[3]}, (f32x4){p[4], p[5], p[6], p[7]});
            *(u32x4*)(dst + (size_t)(2560 + 64 * g + j) * DM + k0 + kc) = pk8((f32x4){q[0], q[1], q[2], q[3]}, (f32x4){q[4], q[5], q[6], q[7]});
        }
    }
    const size_t gt = (size_t)b * 512 + tid, gn = (size_t)G * 512;
    { bf16_t* d4 = (bf16_t*)(ws + WS_DFT4);
      for (size_t i = gt; i < (size_t)4096 * 1024; i += gn) { const int sp = (int)(i >> 10), k0 = (int)(i & 1023) * 8; const int kk = k0 & 4095; const bool isq = k0 >= 4096; float v[8];
#pragma unroll
          for (int e = 0; e < 8; ++e) { const int mi = (sp * (kk + e)) & 4095; float s, c; sincospif((float)mi * (1.f / 2048.f), &s, &c); v[e] = isq ? -s : c; }
          *(u32x4*)(d4 + (size_t)sp * 8192 + k0) = pk8((f32x4){v[0], v[1], v[2], v[3]}, (f32x4){v[4], v[5], v[6], v[7]}); }
      bf16_t* d2 = (bf16_t*)(ws + WS_DFT2);
      for (size_t i = gt; i < (size_t)2048 * 512; i += gn) { const int sp = (int)(i >> 9), k0 = (int)(i & 511) * 8; const int kk = k0 & 2047; const bool isq = k0 >= 2048; float v[8];
#pragma unroll
          for (int e = 0; e < 8; ++e) { const int mi = (sp * (kk + e)) & 2047; float s, c; sincospif((float)mi * (1.f / 1024.f), &s, &c); v[e] = isq ? -s : c; }
          *(u32x4*)(d2 + (size_t)sp * 4096 + k0) = pk8((f32x4){v[0], v[1], v[2], v[3]}, (f32x4){v[4], v[5], v[6], v[7]}); } }
    { float* rc = (float*)(ws + WS_ROPE); float* rsn = rc + 4096 * 32; float* ac = rsn + 4096 * 32; float* as = ac + 64 * 16;
      for (size_t i = gt; i < (size_t)4096 * 32; i += gn) { const int t = (int)(i >> 5), f = (int)(i & 31); const float inv = powf(10000.f, -(float)f / 32.f); const float ang = (float)t * inv; rc[i] = cosf(ang); rsn[i] = sinf(ang); }
      for (size_t i = gt; i < (size_t)64 * 16; i += gn) { const int t = (int)(i >> 4), f = (int)(i & 15); const float inv = powf(10000.f, -(float)f / 16.f); const float ang = (float)t * inv; ac[i] = cosf(ang); as[i] = sinf(ang); } }
    { float* rs = (float*)(ws + WS_ROWSS) + T; for (size_t i = gt; i < (size_t)6 * T; i += gn) rs[i] = 0.f; }
    { const int lane = tid & 63, gw = b * 8 + (tid >> 6), nw = G * 8; bf16_t* xb = (bf16_t*)(ws + WS_XB); float* rs0 = (float*)(ws + WS_ROWSS);
      for (int r = gw; r < T; r += nw) { const float* src = r < TP ? a.in[0] + (size_t)r * DM : a.in[1] + (size_t)(r - TP) * DM; float ss = 0.f;
#pragma unroll
          for (int it = 0; it < 4; ++it) { const f32x4 v = *(const f32x4*)(src + it * 256 + lane * 4); ss += (v[0] * v[0] + v[1] * v[1]) + (v[2] * v[2] + v[3] * v[3]);
              u32x2 w; w.x = pk_bf16(v[0], v[1]); w.y = pk_bf16(v[2], v[3]); *(u32x2*)(xb + (size_t)r * DM + it * 256 + lane * 4) = w; }
#pragma unroll
          for (int o = 32; o > 0; o >>= 1) ss += __shfl_xor(ss, o);
          if (lane == 0) rs0[r] = ss; } }
}

DI void phase_prepass(const Args& a, int layer, size_t gt, size_t gn) {
    unsigned char* ws = a.ws; bf16_t* proj = (bf16_t*)(ws + WS_PROJ); bf16_t* mixed = (bf16_t*)(ws + WS_MIXED);
    const float* ac = (const float*)(ws + WS_ROPE) + 2 * 4096 * 32; const float* as = ac + 64 * 16;
    for (size_t idx = gt; idx < (size_t)T * 96; idx += gn) {
        const int i = (int)(idx & 15); const size_t item = idx >> 4; const int tok = (int)(item / 6), hh = (int)(item % 6);
        const int pos = tok < TP ? (tok & 4095) : ((tok - TP) & 2047);
        bf16_t* p = proj + (size_t)tok * NPROJ + (hh < 4 ? 1024 + 64 * hh : 1280 + 64 * (hh - 4));
        const float* nw = (hh < 4 ? a.in[8] : a.in[9]) + layer * 64;
        float v0 = __uint_as_float((unsigned)p[i] << 16), v1 = __uint_as_float((unsigned)p[16 + i] << 16), v2 = __uint_as_float((unsigned)p[32 + i] << 16), v3 = __uint_as_float((unsigned)p[48 + i] << 16);
        float ss = v0 * v0 + v1 * v1 + v2 * v2 + v3 * v3;
        ss += __shfl_xor(ss, 1); ss += __shfl_xor(ss, 2); ss += __shfl_xor(ss, 4); ss += __shfl_xor(ss, 8);
        const float rs = rsqrtf(ss * (1.f / 64.f) + EPS);
        v0 *= rs * nw[i]; v1 *= rs * nw[16 + i]; v2 *= rs * nw[32 + i]; v3 *= rs * nw[48 + i];
        const int row = pos >> 6, col = pos & 63;
        const float cr = ac[row * 16 + i], sr = as[row * 16 + i], cc = ac[col * 16 + i], sc = as[col * 16 + i];
        const float o0 = v0 * cr - v1 * sr, o1 = v1 * cr + v0 * sr, o2 = v2 * cc - v3 * sc, o3 = v3 * cc + v2 * sc;
        p[i] = (bf16_t)(pk_bf16(o0, 0.f) & 0xffff); p[16 + i] = (bf16_t)(pk_bf16(o1, 0.f) & 0xffff); p[32 + i] = (bf16_t)(pk_bf16(o2, 0.f) & 0xffff); p[48 + i] = (bf16_t)(pk_bf16(o3, 0.f) & 0xffff);
    }
    { bf16_t* vt = (bf16_t*)(ws + WS_VT);
      for (size_t idx = gt; idx < (size_t)(T / 8) * 128; idx += gn) { const int c = (int)(idx & 127); const int tg = (int)(idx >> 7) * 8;
          int S, tok0; if (tg < TP) { S = 4096; tok0 = tg & ~4095; } else { S = 2048; tok0 = TP + ((tg - TP) & ~2047); }
          const int pos = tg - tok0; unsigned short v[8];
#pragma unroll
          for (int e = 0; e < 8; ++e) v[e] = proj[(size_t)(tg + e) * NPROJ + 1408 + c];
          u32x4 w; w.x = v[0] | ((unsigned)v[1] << 16); w.y = v[2] | ((unsigned)v[3] << 16); w.z = v[4] | ((unsigned)v[5] << 16); w.w = v[6] | ((unsigned)v[7] << 16);
          *(u32x4*)(vt + (size_t)tok0 * 128 + (size_t)(c >> 6) * 64 * S + (size_t)(c & 63) * S + pos) = w; } }
    { const float* cw = a.in[10] + layer * 3 * 256;
      for (size_t idx = gt; idx < (size_t)T * 32; idx += gn) { const int tok = (int)(idx >> 5), c0 = (int)(idx & 31) * 8;
          const int S = tok < TP ? 4096 : 2048; const int pos = tok < TP ? (tok & 4095) : ((tok - TP) & 2047);
          float y[8];
#pragma unroll
          for (int e = 0; e < 8; ++e) y[e] = 0.f;
#pragma unroll
          for (int j = 0; j < 3; ++j) { const int pp = pos + j - 1; if (pp < 0 || pp >= S) continue;
              const bf16_t* rp = proj + (size_t)(tok + j - 1) * NPROJ; float cg[8], hv[8];
              unpk8(*(const u32x4*)(rp + 1792 + c0), cg); unpk8(*(const u32x4*)(rp + 2048 + c0), hv);
              const f32x4 w0 = *(const f32x4*)(cw + j * 256 + c0), w1 = *(const f32x4*)(cw + j * 256 + c0 + 4);
#pragma unroll
              for (int e = 0; e < 4; ++e) { y[e] += cg[e] * hv[e] * w0[e]; y[4 + e] += cg[4 + e] * hv[4 + e] * w1[e]; } }
          float bg[8]; unpk8(*(const u32x4*)(proj + (size_t)tok * NPROJ + 1536 + c0), bg);
          *(u32x4*)(mixed + (size_t)tok * DM + 768 + c0) = pk8((f32x4){bg[0] * y[0], bg[1] * y[1], bg[2] * y[2], bg[3] * y[3]}, (f32x4){bg[4] * y[4], bg[5] * y[5], bg[6] * y[6], bg[7] * y[7]}); } }
    { bf16_t* pb = (bf16_t*)(ws + WS_PBF); const float* pp = a.in[2] + (size_t)layer * TP * 256; const float* ps = a.in[3] + (size_t)layer * TS * 256;
      for (size_t idx = gt; idx < (size_t)T * 32; idx += gn) { const float* src = idx < (size_t)TP * 32 ? pp + idx * 8 : ps + (idx - (size_t)TP * 32) * 8;
          *(u32x4*)(pb + idx * 8) = pk8(*(const f32x4*)src, *(const f32x4*)(src + 4)); } }
}

constexpr int R_KS = 0, R_KT = 18432, R_VT = R_KT + 17408, R_ST = R_VT + 17408, R_DIR = R_ST + 9216;
DI void phase_retention(LAS unsigned char* lds, const Args& a, int layer, int chain) {
    unsigned char* ws = a.ws; const bf16_t* proj = (const bf16_t*)(ws + WS_PROJ); bf16_t* mixed = (bf16_t*)(ws + WS_MIXED); float* rpart = (float*)(ws + WS_RPART);
    const float* ropec = (const float*)(ws + WS_ROPE); const float* ropes = ropec + 4096 * 32;
    int tid = threadIdx.x; asm volatile("" : "+v"(tid));
    const int wave = tid >> 6, lane = tid & 63, dir = wave >> 2, w = wave & 3, tid2 = tid & 255, r = lane & 31, h = lane >> 5;
    int tok0, N, head;
    if (chain < 64) { tok0 = (chain >> 2) * 4096; N = 32; head = chain & 3; } else { const int c2 = chain - 64; tok0 = TP + (c2 >> 2) * 2048; N = 16; head = c2 & 3; }
    const float lg2 = -__expf(a.in[6][layer * 8 + dir * 4 + head]) * 1.44269504f;
    const float gC = ex2(lg2 * 128.f); const int sgn = 1 - 2 * dir;
    LAS unsigned char* L = lds + dir * R_DIR;
    for (int i = tid2; i < 9216 / 4; i += 256) ((LAS unsigned*)(L + R_ST))[i] = 0u;
    f32x16 st; for (int i = 0; i < 16; ++i) st[i] = 0.f;
    const int db_s = w >> 1, eb_s = w & 1;
    const float* gnw = a.in[7] + layer * 256 + head * 64;
    for (int n = 0; n < N; ++n) {
        const int c = dir ? N - 1 - n : n; const int tb = tok0 + c * 128, pos0 = c * 128;
        { const int key = tid2 >> 1, hh = tid2 & 1; const bf16_t* rowp = proj + (size_t)(tb + key) * NPROJ + head * 64;
          const float* ct = ropec + (size_t)(pos0 + key) * 32; const float* sn = ropes + (size_t)(pos0 + key) * 32;
          const float zeta = ex2(lg2 * (float)(dir ? key : 127 - key));
#pragma unroll 1
          for (int pr = 0; pr < 2; ++pr) {
              float x1[8], x2[8], y1[8], y2[8]; unpk8(*(const u32x4*)(rowp + 256 + 16 * pr + 8 * hh), x1); unpk8(*(const u32x4*)(rowp + 256 + 32 + 16 * pr + 8 * hh), x2);
              const f32x4 ca = *(const f32x4*)(ct + 16 * pr + 8 * hh), cb = *(const f32x4*)(ct + 16 * pr + 8 * hh + 4), sa = *(const f32x4*)(sn + 16 * pr + 8 * hh), sb = *(const f32x4*)(sn + 16 * pr + 8 * hh + 4);
#pragma unroll
              for (int j = 0; j < 8; ++j) { const float cs = j < 4 ? ca[j & 3] : cb[j & 3], sv = j < 4 ? sa[j & 3] : sb[j & 3];
                  y1[j] = (x1[j] * cs - x2[j] * sv) * 0.125f; y2[j] = (x2[j] * cs + x1[j] * sv) * 0.125f; }
              const int d1 = 16 * pr + 8 * hh, d2 = 32 + d1;
              *(LAS u32x4*)(L + R_KS + key * 144 + d1 * 2) = pk8((f32x4){y1[0], y1[1], y1[2], y1[3]}, (f32x4){y1[4], y1[5], y1[6], y1[7]});
              *(LAS u32x4*)(L + R_KS + key * 144 + d2 * 2) = pk8((f32x4){y2[0], y2[1], y2[2], y2[3]}, (f32x4){y2[4], y2[5], y2[6], y2[7]});
#pragma unroll
              for (int j = 0; j < 8; j += 2) { const unsigned u1 = pk_bf16(y1[j] * zeta, y1[j + 1] * zeta), u2 = pk_bf16(y2[j] * zeta, y2[j + 1] * zeta);
                  *(LAS unsigned short*)(L + R_KT + (d1 + j) * 272 + key * 2) = (unsigned short)(u1 & 0xffff); *(LAS unsigned short*)(L + R_KT + (d1 + j + 1) * 272 + key * 2) = (unsigned short)(u1 >> 16);
                  *(LAS unsigned short*)(L + R_KT + (d2 + j) * 272 + key * 2) = (unsigned short)(u2 & 0xffff); *(LAS unsigned short*)(L + R_KT + (d2 + j + 1) * 272 + key * 2) = (unsigned short)(u2 >> 16); }
          }
#pragma unroll
          for (int q4 = 0; q4 < 4; ++q4) { const int d0 = 32 * hh + 8 * q4; const u32x4 vv = *(const u32x4*)(rowp + 512 + d0);
              const unsigned uu[4] = {vv.x, vv.y, vv.z, vv.w};
#pragma unroll
              for (int j = 0; j < 4; ++j) { *(LAS unsigned short*)(L + R_VT + (d0 + 2 * j) * 272 + key * 2) = (unsigned short)(uu[j] & 0xffff); *(LAS unsigned short*)(L + R_VT + (d0 + 2 * j + 1) * 272 + key * 2) = (unsigned short)(uu[j] >> 16); } }
        }
        bf16x8 qf[4];
        const int iq = 32 * w + r; const int qtok = tb + iq;
        { const bf16_t* rowp = proj + (size_t)qtok * NPROJ + head * 64; const float* ct = ropec + (size_t)(pos0 + iq) * 32; const float* sn = ropes + (size_t)(pos0 + iq) * 32;
#pragma unroll
          for (int pr = 0; pr < 2; ++pr) { float x1[8], x2[8], y1[8], y2[8]; unpk8(*(const u32x4*)(rowp + 16 * pr + 8 * h), x1); unpk8(*(const u32x4*)(rowp + 32 + 16 * pr + 8 * h), x2);
              const f32x4 ca = *(const f32x4*)(ct + 16 * pr + 8 * h), cb = *(const f32x4*)(ct + 16 * pr + 8 * h + 4), sa = *(const f32x4*)(sn + 16 * pr + 8 * h), sb = *(const f32x4*)(sn + 16 * pr + 8 * h + 4);
#pragma unroll
              for (int j = 0; j < 8; ++j) { const float cs = j < 4 ? ca[j & 3] : cb[j & 3], sv = j < 4 ? sa[j & 3] : sb[j & 3]; y1[j] = x1[j] * cs - x2[j] * sv; y2[j] = x2[j] * cs + x1[j] * sv; }
              qf[pr] = __builtin_bit_cast(bf16x8, pk8((f32x4){y1[0], y1[1], y1[2], y1[3]}, (f32x4){y1[4], y1[5], y1[6], y1[7]}));
              qf[2 + pr] = __builtin_bit_cast(bf16x8, pk8((f32x4){y2[0], y2[1], y2[2], y2[3]}, (f32x4){y2[4], y2[5], y2[6], y2[7]})); } }
        __syncthreads();
        f32x16 o[2]; for (int i = 0; i < 16; ++i) { o[0][i] = 0.f; o[1][i] = 0.f; }
#pragma unroll 1
        for (int kb = 0; kb < 4; ++kb) {
            f32x16 x; for (int i = 0; i < 16; ++i) x[i] = 0.f;
#pragma unroll
            for (int s = 0; s < 4; ++s) { const bf16x8 ka = *(const LAS bf16x8*)(L + R_KS + (32 * kb + r) * 144 + (16 * s + 8 * h) * 2); x = MFMA32(ka, qf[s], x); }
#pragma unroll
            for (int i = 0; i < 16; ++i) { const int j = 32 * kb + (i & 3) + 8 * (i >> 2) + 4 * h; const int dl = (iq - j) * sgn - dir; const float fm = (float)(dl >> 31) * 4000.f;
                x[i] = x[i] * ex2(lg2 * (float)(dl + dir) + fm); }
#pragma unroll
            for (int s2 = 0; s2 < 2; ++s2) {
                const bf16x8 pf = __builtin_bit_cast(bf16x8, pk8((f32x4){x[8 * s2], x[8 * s2 + 1], x[8 * s2 + 2], x[8 * s2 + 3]}, (f32x4){x[8 * s2 + 4], x[8 * s2 + 5], x[8 * s2 + 6], x[8 * s2 + 7]}));
#pragma unroll
                for (int db = 0; db < 2; ++db) { const LAS unsigned char* vp = L + R_VT + (32 * db + r) * 272 + (32 * kb + 16 * s2 + 4 * h) * 2;
                    const s16x4 lo = *(const LAS s16x4*)vp, hi = *(const LAS s16x4*)(vp + 16);
                    o[db] = MFMA32(__builtin_shufflevector(lo, hi, 0, 1, 2, 3, 4, 5, 6, 7), pf, o[db]); } }
        }
        { const float xi = ex2(lg2 * (float)(dir ? 128 - iq : iq + 1));
#pragma unroll
          for (int eb = 0; eb < 2; ++eb) { f32x16 cx; for (int i = 0; i < 16; ++i) cx[i] = 0.f;
#pragma unroll
              for (int s = 0; s < 4; ++s) { const bf16x8 sa = *(const LAS bf16x8*)(L + R_ST + (32 * eb + r) * 144 + (16 * s + 8 * h) * 2); cx = MFMA32(sa, qf[s], cx); }
#pragma unroll
              for (int i = 0; i < 16; ++i) o[eb][i] += xi * cx[i]; } }
#pragma unroll
        for (int i = 0; i < 16; ++i) st[i] *= gC;
#pragma unroll
        for (int s = 0; s < 8; ++s) { const bf16x8 ka = *(const LAS bf16x8*)(L + R_KT + (32 * db_s + r) * 272 + (16 * s + 8 * h) * 2), vb = *(const LAS bf16x8*)(L + R_VT + (32 * eb_s + r) * 272 + (16 * s + 8 * h) * 2);
            st = MFMA32(ka, vb, st); }
        __syncthreads();
#pragma unroll
        for (int ig = 0; ig < 4; ++ig) { u32x2 wv; wv.x = pk_bf16(st[4 * ig], st[4 * ig + 1]); wv.y = pk_bf16(st[4 * ig + 2], st[4 * ig + 3]);
            *(LAS u32x2*)(L + R_ST + (32 * eb_s + r) * 144 + (32 * db_s + 8 * ig + 4 * h) * 2) = wv; }
        float* pp = rpart + (((size_t)(tb >> 7) * 4 + head) * 4 + w) * 2048 + lane;
        if (2 * n < N) {
#pragma unroll
            for (int db = 0; db < 2; ++db)
#pragma unroll
                for (int i = 0; i < 16; ++i) pp[(db * 16 + i) * 64] = o[db][i];
        } else {
            float s1 = 0.f;
#pragma unroll
            for (int db = 0; db < 2; ++db)
#pragma unroll
                for (int i = 0; i < 16; ++i) { o[db][i] += pp[(db * 16 + i) * 64]; s1 += o[db][i]; }
            s1 += __shfl_xor(s1, 32); const float mu = s1 * (1.f / 64.f); float s2 = 0.f;
#pragma unroll
            for (int db = 0; db < 2; ++db)
#pragma unroll
                for (int i = 0; i < 16; ++i) { const float dd = o[db][i] - mu; s2 += dd * dd; }
            s2 += __shfl_xor(s2, 32); const float rstd = rsqrtf(s2 * (1.f / 64.f) + EPS);
            const bf16_t* grow = proj + (size_t)qtok * NPROJ + 768 + head * 64; bf16_t* orow = mixed + (size_t)qtok * DM + head * 64;
#pragma unroll
            for (int db = 0; db < 2; ++db)
#pragma unroll
                for (int ig = 0; ig < 4; ++ig) { const int d0 = 32 * db + 8 * ig + 4 * h; const u32x2 gv = *(const u32x2*)(grow + d0); const f32x4 gw = *(const f32x4*)(gnw + d0);
                    const float g4[4] = {bflo(gv.x), bfhi(gv.x), bflo(gv.y), bfhi(gv.y)}; float y[4];
#pragma unroll
                    for (int j = 0; j < 4; ++j) { const float gg = g4[j]; const float sl = gg / (1.f + __expf(-gg)); y[j] = sl * (o[db][4 * ig + j] - mu) * rstd * gw[j]; }
                    u32x2 wv; wv.x = pk_bf16(y[0], y[1]); wv.y = pk_bf16(y[2], y[3]); *(u32x2*)(orow + d0) = wv; }
        }
    }
    __syncthreads();
}

DI void attn_item(LAS unsigned char* lds, const Args& a, int tok0, int S, int kvh, int qb) {
    unsigned char* ws = a.ws; const bf16_t* proj = (const bf16_t*)(ws + WS_PROJ); bf16_t* mixed = (bf16_t*)(ws + WS_MIXED); const bf16_t* vt = (const bf16_t*)(ws + WS_VT);
    int tid = threadIdx.x; asm volatile("" : "+v"(tid));
    const int wave = tid >> 6, lane = tid & 63, r = lane & 31, h = lane >> 5;
    const int hq = 2 * kvh + (wave >> 2); const int qtok = tok0 + qb * 128 + 32 * (wave & 3) + r;
    bf16x8 qf[4];
    { const bf16_t* qrow = proj + (size_t)qtok * NPROJ + 1024 + hq * 64;
#pragma unroll
      for (int s = 0; s < 4; ++s) qf[s] = *(const bf16x8*)(qrow + 16 * s + 8 * h); }
    const bf16_t* kbase = proj + (size_t)tok0 * NPROJ + 1280 + kvh * 64;
    const bf16_t* vbase = vt + (size_t)tok0 * 128 + (size_t)kvh * 64 * S;
    const int srow = tid >> 3, sch = (tid & 7) * 8;
    LAS unsigned char* Ks = lds; LAS unsigned char* Vs = lds + 2 * 9216;
    const int nt = S / 64;
    u32x4 kreg = *(const u32x4*)(kbase + (size_t)srow * NPROJ + sch), vreg = *(const u32x4*)(vbase + (size_t)srow * S + sch);
    __syncthreads();
    *(LAS u32x4*)(Ks + srow * 144 + sch * 2) = kreg; *(LAS u32x4*)(Vs + srow * 144 + sch * 2) = vreg;
    __syncthreads();
    f32x16 o[2]; for (int i = 0; i < 16; ++i) { o[0][i] = 0.f; o[1][i] = 0.f; }
    float m_run = -1e30f, l_run = 0.f;
    const float csc = 0.125f * 1.44269504f;
    for (int t = 0; t < nt; ++t) {
        const int cur = t & 1;
        if (t + 1 < nt) { kreg = *(const u32x4*)(kbase + (size_t)((t + 1) * 64 + srow) * NPROJ + sch); vreg = *(const u32x4*)(vbase + (size_t)srow * S + (t + 1) * 64 + sch); }
        const LAS unsigned char* kc = Ks + cur * 9216; const LAS unsigned char* vc = Vs + cur * 9216;
        f32x16 x[2];
#pragma unroll
        for (int kb = 0; kb < 2; ++kb) { for (int i = 0; i < 16; ++i) x[kb][i] = 0.f;
#pragma unroll
            for (int s = 0; s < 4; ++s) { const bf16x8 ka = *(const LAS bf16x8*)(kc + (32 * kb + r) * 144 + (16 * s + 8 * h) * 2); x[kb] = MFMA32(ka, qf[s], x[kb]); } }
        float mx = x[0][0];
#pragma unroll
        for (int kb = 0; kb < 2; ++kb)
#pragma unroll
            for (int i = 0; i < 16; ++i) mx = fmaxf(mx, x[kb][i]);
        mx = fmaxf(mx, __shfl_xor(mx, 32));
        const float m_new = fmaxf(m_run, mx * csc); const float alpha = ex2(m_run - m_new); m_run = m_new;
        float ls = 0.f;
#pragma unroll
        for (int kb = 0; kb < 2; ++kb)
#pragma unroll
            for (int i = 0; i < 16; ++i) { const float p = ex2(x[kb][i] * csc - m_new); x[kb][i] = p; ls += p; }
        l_run = l_run * alpha + ls;
#pragma unroll
        for (int i = 0; i < 16; ++i) { o[0][i] *= alpha; o[1][i] *= alpha; }
#pragma unroll
        for (int kb = 0; kb < 2; ++kb)
#pragma unroll
            for (int s2 = 0; s2 < 2; ++s2) {
                const bf16x8 pf = __builtin_bit_cast(bf16x8, pk8((f32x4){x[kb][8 * s2], x[kb][8 * s2 + 1], x[kb][8 * s2 + 2], x[kb][8 * s2 + 3]}, (f32x4){x[kb][8 * s2 + 4], x[kb][8 * s2 + 5], x[kb][8 * s2 + 6], x[kb][8 * s2 + 7]}));
#pragma unroll
                for (int db = 0; db < 2; ++db) { const LAS unsigned char* vp = vc + (32 * db + r) * 144 + (32 * kb + 16 * s2 + 4 * h) * 2;
                    const s16x4 lo = *(const LAS s16x4*)vp, hi = *(const LAS s16x4*)(vp + 16);
                    o[db] = MFMA32(__builtin_shufflevector(lo, hi, 0, 1, 2, 3, 4, 5, 6, 7), pf, o[db]); } }
        if (t + 1 < nt) { *(LAS u32x4*)(Ks + (cur ^ 1) * 9216 + srow * 144 + sch * 2) = kreg; *(LAS u32x4*)(Vs + (cur ^ 1) * 9216 + srow * 144 + sch * 2) = vreg; }
        __syncthreads();
    }
    l_run += __shfl_xor(l_run, 32); const float inv = 1.f / l_run;
    bf16_t* orow = mixed + (size_t)qtok * DM + 512 + hq * 64;
#pragma unroll
    for (int db = 0; db < 2; ++db)
#pragma unroll
        for (int ig = 0; ig < 4; ++ig) { u32x2 wv; wv.x = pk_bf16(o[db][4 * ig] * inv, o[db][4 * ig + 1] * inv); wv.y = pk_bf16(o[db][4 * ig + 2] * inv, o[db][4 * ig + 3] * inv);
            *(u32x2*)(orow + 32 * db + 8 * ig + 4 * h) = wv; }
}
DI void phase_attention(LAS unsigned char* lds, const Args& a) {
    const int G = gridDim.x, b = blockIdx.x;
    for (int it = b; it < 1024; it += G) { const int sk = it >> 5, qb = it & 31; attn_item(lds, a, (sk >> 1) * 4096, 4096, sk & 1, qb); }
    for (int it = b; it < 256; it += G) { const int sk = it >> 4, qb = it & 15; attn_item(lds, a, TP + (sk >> 1) * 2048, 2048, sk & 1, qb); }
}

typedef const __attribute__((address_space(4))) Args* ArgsCP;
DI Args load_args(ArgsCP q) { Args a; _Pragma("unroll") for (int i = 0; i < 19; ++i) a.in[i] = q->in[i]; a.out = q->out; a.ws = q->ws; return a; }
#define LOADARGS() ({ ArgsCP q_ = ap; asm volatile("" : "+s"(q_)); load_args(q_); })
template <int MASK> __global__ void __launch_bounds__(512) mega_t(Args a_unused) {
    extern __shared__ __attribute__((aligned(16))) unsigned char lds_raw[];
    LAS unsigned char* lds = (LAS unsigned char*)lds_raw;
    cg::grid_group grid = cg::this_grid();
    ArgsCP ap = (ArgsCP)__builtin_amdgcn_kernarg_segment_ptr();
    const int G0 = gridDim.x, b0 = blockIdx.x;
#define LAUNDER_GB() int G = G0, b = b0; asm volatile("" : "+s"(G), "+s"(b));

    if constexpr (MASK & 1) { LAUNDER_GB(); const Args a = LOADARGS(); phase_prep(lds, a); }
    grid.sync();

    for (int l = 0; l < 2; ++l) {
        if constexpr (MASK & 2) { LAUNDER_GB(); const Args a = LOADARGS(); unsigned char* ws = a.ws; const unsigned char* wl = ws + WS_W + (size_t)l * W_LAYER;
          const bf16_t* xin = (const bf16_t*)(ws + (l == 0 ? WS_XB : WS_MIXED)); float* rowss = (float*)(ws + WS_ROWSS);
          pg8::Gemm g{xin, (const bf16_t*)(wl + W_IN), T, NPROJ, DM}; pg8::StaticOrder S; S.init(T, NPROJ, G, b); EpiProj E{(bf16_t*)(ws + WS_PROJ), rowss + (size_t)(3 * l) * T};
          pg8::gemm_phase(lds, g, S, E); }
        if constexpr (MASK & 4) { LAUNDER_GB(); const Args a = LOADARGS(); unsigned char* ws = a.ws; const unsigned char* wl = ws + WS_W + (size_t)l * W_LAYER;
          const bf16_t* xin = (const bf16_t*)(ws + (l == 0 ? WS_XB : WS_MIXED)); float* rowss = (float*)(ws + WS_ROWSS);
          pg8::Gemm g{(const bf16_t*)(wl + W_IN) + (size_t)NPROJ * DM, xin, 512, T, DM}; pg8::StaticOrder S; S.init(512, T, G, b); EpiPQ E{(bf16_t*)(ws + WS_PQT), rowss + (size_t)(3 * l) * T};
          pg8::gemm_phase(lds, g, S, E); }
        grid.sync();
        if (b0 < NRET) { if constexpr (MASK & 8) { LAUNDER_GB(); const Args a = LOADARGS(); phase_retention(lds, a, l, b); } }
        else if constexpr (MASK & 16) {
            int G2 = G0 - NRET, c2 = b0 - NRET; asm volatile("" : "+s"(G2), "+s"(c2));
            { LAUNDER_GB(); const Args a = LOADARGS(); int tid = threadIdx.x; asm volatile("" : "+v"(tid)); phase_prepass(a, l, (size_t)c2 * 512 + tid, (size_t)G2 * 512); }
            __syncthreads();
            { LAUNDER_GB(); const Args a = LOADARGS(); unsigned char* ws = a.ws;
              pg8::Gemm g{(const bf16_t*)(ws + WS_DFT4), (const bf16_t*)(ws + WS_PQT), 4096, 4096, 8192}; pg8::StaticOrder S; S.init(4096, 4096, G2, c2); EpiDft E{(bf16_t*)(ws + WS_MIXED), 1.f / 512.f, 0, 4096};
              pg8::gemm_phase(lds, g, S, E); }
            if (c2 >= G2 - 64) { LAUNDER_GB(); const Args a = LOADARGS(); unsigned char* ws = a.ws;
              pg8::Gemm g{(const bf16_t*)(ws + WS_DFT2), (const bf16_t*)(ws + WS_PQT) + (size_t)16 * 256 * 8192, 2048, 2048, 4096}; pg8::StaticOrder S; S.init(2048, 2048, 64, c2 - (G2 - 64)); EpiDft E{(bf16_t*)(ws + WS_MIXED), 0.00276213586f, TP, 2048};
              pg8::gemm_phase(lds, g, S, E); }
        }
        grid.sync();
        if constexpr (MASK & 32) { LAUNDER_GB(); const Args a = LOADARGS(); phase_attention(lds, a); }
        grid.sync();
        if constexpr (MASK & 64) { LAUNDER_GB(); const Args a = LOADARGS(); unsigned char* ws = a.ws; const unsigned char* wl = ws + WS_W + (size_t)l * W_LAYER; float* rowss = (float*)(ws + WS_ROWSS);
          pg8::Gemm g{(const bf16_t*)(ws + WS_MIXED), (const bf16_t*)(wl + W_OUT), T, DM, DM}; pg8::StaticOrder S; S.init(T, DM, G, b);
          EpiResid E{l == 0 ? a.in[0] : a.out, l == 0 ? a.in[1] : a.out + (size_t)TP * DM, a.out, (bf16_t*)(ws + WS_XB), rowss + (size_t)(3 * l + 1) * T};
          pg8::gemm_phase(lds, g, S, E); }
        grid.sync();
        if constexpr (MASK & 128) { LAUNDER_GB(); const Args a = LOADARGS(); unsigned char* ws = a.ws; const unsigned char* wl = ws + WS_W + (size_t)l * W_LAYER; float* rowss = (float*)(ws + WS_ROWSS);
          pg8::Gemm g{(const bf16_t*)(ws + WS_XB), (const bf16_t*)(wl + W_1), T, DFF, DM}; pg8::StaticOrder S; S.init(T, DFF, G, b); EpiFfn1 E{(bf16_t*)(ws + WS_HIDDEN), rowss + (size_t)(3 * l + 1) * T};
          pg8::gemm_phase(lds, g, S, E); }
        grid.sync();
        if constexpr (MASK & 256) { LAUNDER_GB(); const Args a = LOADARGS(); unsigned char* ws = a.ws; const unsigned char* wl = ws + WS_W + (size_t)l * W_LAYER; float* rowss = (float*)(ws + WS_ROWSS);
          pg8::Gemm g{(const bf16_t*)(ws + WS_HIDDEN), (const bf16_t*)(wl + W_2), T, DM, DFF}; pg8::StaticOrder S; S.init(T, DM, G, b);
          EpiResid E{a.out, a.out + (size_t)TP * DM, a.out, (bf16_t*)(ws + WS_XB), rowss + (size_t)(3 * l + 2) * T};
          pg8::gemm_phase(lds, g, S, E); }
        grid.sync();
        if constexpr (MASK & 512) { LAUNDER_GB(); const Args a = LOADARGS(); unsigned char* ws = a.ws; const unsigned char* wl = ws + WS_W + (size_t)l * W_LAYER;
          pg8::Gemm g{(const bf16_t*)(ws + WS_PBF), (const bf16_t*)(wl + W_P), T, DM, 256}; pg8::StaticOrder S; S.init(T, DM, G, b); EpiPP E{(bf16_t*)(ws + WS_PP)};
          pg8::gemm_phase(lds, g, S, E); }
        __threadfence(); __syncthreads();
        if constexpr (MASK & 1024) { LAUNDER_GB(); const Args a = LOADARGS(); unsigned char* ws = a.ws; const unsigned char* wl = ws + WS_W + (size_t)l * W_LAYER; float* rowss = (float*)(ws + WS_ROWSS);
          pg8::Gemm g{(const bf16_t*)(ws + WS_XB), (const bf16_t*)(wl + W_G), T, DM, DM}; pg8::StaticOrder S; S.init(T, DM, G, b);
          EpiGate E{rowss + (size_t)(3 * l + 2) * T, (const bf16_t*)(ws + WS_PP), a.out, (bf16_t*)(ws + WS_MIXED), rowss + (size_t)(3 * l + 3) * T};
          pg8::gemm_phase(lds, g, S, E); }
        grid.sync();
    }
    { LAUNDER_GB(); const Args a = LOADARGS(); int tid = threadIdx.x; asm volatile("" : "+v"(tid));
      const int lane = tid & 63, gw = b * 8 + (tid >> 6), nw = G * 8; const float* rs6 = (const float*)(a.ws + WS_ROWSS) + (size_t)6 * T; const float* fw = a.in[18];
      for (int r = gw; r < T; r += nw) { const float rs = rsqrtf(rs6[r] * (1.f / 1024.f) + EPS); float* p = a.out + (size_t)r * DM;
#pragma unroll
          for (int it = 0; it < 4; ++it) { f32x4 v = *(f32x4*)(p + it * 256 + lane * 4); const f32x4 wv = *(const f32x4*)(fw + it * 256 + lane * 4); v = v * rs * wv; *(f32x4*)(p + it * 256 + lane * 4) = v; } } }
}

#ifndef KMASK
#define KMASK 2047
#endif
#ifdef ANALYZE
template __global__ void mega_t<1>(Args);template __global__ void mega_t<2>(Args);template __global__ void mega_t<4>(Args);template __global__ void mega_t<8>(Args);template __global__ void mega_t<16>(Args);template __global__ void mega_t<32>(Args);template __global__ void mega_t<64>(Args);template __global__ void mega_t<128>(Args);template __global__ void mega_t<256>(Args);template __global__ void mega_t<512>(Args);template __global__ void mega_t<1024>(Args);
#endif
extern "C" void kernel_launch(void* const* d_in, const int* in_sizes, int n_in, void* d_out, int out_size, void* d_ws, size_t ws_size, hipStream_t stream) {
    static int grid = 0;
    if (grid == 0) {
        int dev = 0, cus = 0, per = 0;
        if (n_in != 19 || out_size != T * DM || ws_size < WS_END) { fprintf(stderr, "kernel_launch: unexpected shapes: n_in %d out %d ws %zu (need %zu)\n", n_in, out_size, ws_size, (size_t)WS_END); grid = -1; return; }
        (void)hipGetDevice(&dev); (void)hipDeviceGetAttribute(&cus, hipDeviceAttributeMultiprocessorCount, dev);
        if (hipFuncSetAttribute((const void*)mega_t<KMASK>, hipFuncAttributeMaxDynamicSharedMemorySize, LDS_BYTES) != hipSuccess) { fprintf(stderr, "kernel_launch: hipFuncSetAttribute failed\n"); grid = -1; return; }
        (void)hipOccupancyMaxActiveBlocksPerMultiprocessor(&per, (const void*)mega_t<KMASK>, 512, LDS_BYTES);
        fprintf(stderr, "kernel_launch: cus %d, blocks/CU %d, ws %zu\n", cus, per, ws_size);
        grid = cus >= 256 ? 256 : -1;
        if (grid < 0) { fprintf(stderr, "kernel_launch: needs 256 CUs\n"); return; }
    }
    if (grid < 0) return;
    Args a{};
    for (int i = 0; i < 19; ++i) a.in[i] = (const float*)d_in[i];
    a.out = (float*)d_out; a.ws = (unsigned char*)d_ws;
    void* args[] = {&a};
    hipError_t e = hipLaunchCooperativeKernel((void*)mega_t<KMASK>, dim3(grid), dim3(512), args, LDS_BYTES, stream);
    if (e != hipSuccess) fprintf(stderr, "kernel_launch: cooperative launch failed: %s\n", hipGetErrorString(e));
}
```
